# Optimizing an MI355X kernel written in HIP

```python
import math
import jax
import jax.numpy as jnp
from jax import lax
import numpy as np

D_MODEL = 2048
BATCH = 4
SEQ = 2048
DEPTH = 1

HEAD_DIM = D_MODEL // 16
N_HEADS_MOBA = 6
N_HEADS_FOX = 6
N_HEADS_MEM = 4
W_MOBA = N_HEADS_MOBA * HEAD_DIM
W_FOX = N_HEADS_FOX * HEAD_DIM
W_MEM = N_HEADS_MEM * HEAD_DIM
MIX_WIDTH = W_MOBA + W_FOX + W_MEM
IN_WIDTH = 4 * W_MOBA + 4 * W_FOX + N_HEADS_FOX + 2 * W_MEM
N_MEM = 256
MOBA_BLOCK = 256
MOBA_TOPK = 3
MOBA_Q_CHUNK = 16
FOX_Q_BLOCK = 128
T5_BUCKETS = 32
T5_MAX_DIST = 128
EPS = 1e-6
NEG = -1e30

kernel_name = "hybrid_moba_fox_memory_parallel_heads"


def rms_norm(x, g):
    xf = x.astype(jnp.float32)
    y = xf * lax.rsqrt(jnp.mean(xf * xf, axis=-1, keepdims=True) + EPS)
    return (y * g.astype(jnp.float32)).astype(x.dtype)


def split_heads(t, n_heads):
    b, s, _ = t.shape
    return t.reshape(b, s, n_heads, HEAD_DIM).transpose(0, 2, 1, 3)


def merge_heads(t):
    b, h, s, d = t.shape
    return t.transpose(0, 2, 1, 3).reshape(b, s, h * d)


def t5_bucket(dist):
    n = jnp.maximum(dist, 0)
    max_exact = T5_BUCKETS // 2
    nf = jnp.maximum(n, 1).astype(jnp.float32)
    large = max_exact + (jnp.log(nf / max_exact) / math.log(T5_MAX_DIST / max_exact)
                         * (T5_BUCKETS - max_exact)).astype(jnp.int32)
    large = jnp.minimum(large, T5_BUCKETS - 1)
    return jnp.where(n < max_exact, n, large)


def in_splits():
    sizes = [W_MOBA] * 4 + [W_FOX] * 4 + [N_HEADS_FOX] + [W_MEM] * 2
    return [int(v) for v in np.cumsum(sizes)[:-1]]


def moba_attention(q, k, v, rel_bias):
    b, h, s, dh = q.shape
    nb = -(-s // MOBA_BLOCK)
    pad = nb * MOBA_BLOCK - s
    k_blk = jnp.pad(k, ((0, 0), (0, 0), (0, pad), (0, 0))).reshape(b, h, nb, MOBA_BLOCK, dh)
    v_blk = jnp.pad(v, ((0, 0), (0, 0), (0, pad), (0, 0))).reshape(b, h, nb, MOBA_BLOCK, dh)
    k_mean = jnp.mean(k_blk.astype(jnp.float32), axis=3)
    scale = dh ** -0.5
    kk = max(min(MOBA_TOPK, nb - 1), 1)
    q_blk_id = jnp.arange(s) // MOBA_BLOCK
    gate = jnp.einsum('bhsd,bhnd->bhsn', q, k_mean.astype(q.dtype),
                      preferred_element_type=jnp.float32)
    past = jnp.arange(nb)[None, :] < q_blk_id[:, None]
    gate = jnp.where(past, gate, NEG)
    _, sel = lax.top_k(gate, kk)
    sel_valid = sel < q_blk_id[:, None]

    n_chunks = s // MOBA_Q_CHUNK
    q_c = q.reshape(b, h, n_chunks, MOBA_Q_CHUNK, dh).transpose(2, 0, 1, 3, 4)
    sel_c = sel.reshape(b, h, n_chunks, MOBA_Q_CHUNK, kk).transpose(2, 0, 1, 3, 4)
    val_c = sel_valid.reshape(b, h, n_chunks, MOBA_Q_CHUNK, kk).transpose(2, 0, 1, 3, 4)
    starts = jnp.arange(n_chunks, dtype=jnp.int32) * MOBA_Q_CHUNK
    b_idx = jnp.arange(b)[:, None, None, None]
    h_idx = jnp.arange(h)[None, :, None, None]
    h_idx5 = h_idx[..., None]
    blk_off = jnp.arange(MOBA_BLOCK)

    def chunk_fn(args):
        qc, selc, validc, start = args
        tq = start + jnp.arange(MOBA_Q_CHUNK)
        own = start // MOBA_BLOCK
        k_own = lax.dynamic_index_in_dim(k_blk, own, axis=2, keepdims=False)
        v_own = lax.dynamic_index_in_dim(v_blk, own, axis=2, keepdims=False)
        dist_own = tq[:, None] - (own * MOBA_BLOCK + blk_off)[None, :]
        l_own = jnp.einsum('bhqd,bhkd->bhqk', qc, k_own,
                           preferred_element_type=jnp.float32) * scale
        l_own = l_own + rel_bias[:, t5_bucket(dist_own)]
        l_own = jnp.where(dist_own >= 0, l_own, NEG)
        k_sel = k_blk[b_idx, h_idx, selc]
        v_sel = v_blk[b_idx, h_idx, selc]
        l_sel = jnp.einsum('bhqd,bhqnkd->bhqnk', qc, k_sel,
                           preferred_element_type=jnp.float32) * scale
        dist_sel = tq[None, None, :, None, None] - (selc[..., None] * MOBA_BLOCK + blk_off)
        l_sel = l_sel + rel_bias[h_idx5, t5_bucket(dist_sel)]
        l_sel = jnp.where(validc[..., None], l_sel, NEG)
        l_sel = l_sel.reshape(b, h, MOBA_Q_CHUNK, kk * MOBA_BLOCK)
        p = jax.nn.softmax(jnp.concatenate([l_sel, l_own], axis=-1), axis=-1).astype(v.dtype)
        out = jnp.einsum('bhqm,bhqmd->bhqd', p[..., :kk * MOBA_BLOCK],
                         v_sel.reshape(b, h, MOBA_Q_CHUNK, kk * MOBA_BLOCK, dh))
        out = out + jnp.einsum('bhqk,bhkd->bhqd', p[..., kk * MOBA_BLOCK:], v_own)
        return out.astype(q.dtype)

    out = lax.map(chunk_fn, (q_c, sel_c, val_c, starts))
    return out.transpose(1, 2, 0, 3, 4).reshape(b, h, s, dh)


def forgetting_attention(q, k, v, log_f):
    b, h, s, dh = q.shape
    c = jnp.cumsum(log_f, axis=-1)
    n_blk = s // FOX_Q_BLOCK
    q_c = q.reshape(b, h, n_blk, FOX_Q_BLOCK, dh).transpose(2, 0, 1, 3, 4)
    c_c = c.reshape(b, h, n_blk, FOX_Q_BLOCK).transpose(2, 0, 1, 3)
    starts = jnp.arange(n_blk, dtype=jnp.int32) * FOX_Q_BLOCK
    kpos = jnp.arange(s)
    scale = dh ** -0.5

    def blk_fn(args):
        qb, cb, start = args
        tq = start + jnp.arange(FOX_Q_BLOCK)
        l = jnp.einsum('bhqd,bhkd->bhqk', qb, k, preferred_element_type=jnp.float32) * scale
        l = l + cb[..., None] - c[:, :, None, :]
        l = jnp.where(kpos[None, :] <= tq[:, None], l, NEG)
        p = jax.nn.softmax(l, axis=-1).astype(v.dtype)
        return jnp.einsum('bhqk,bhkd->bhqd', p, v)

    out = lax.map(blk_fn, (q_c, c_c, starts))
    return out.transpose(1, 2, 0, 3, 4).reshape(b, h, s, dh)


def memory_attention(q, k, v):
    l = jnp.einsum('bhqd,bhmd->bhqm', q, k, preferred_element_type=jnp.float32) * (HEAD_DIM ** -0.5)
    p = jax.nn.softmax(l, axis=-1).astype(v.dtype)
    return jnp.einsum('bhqm,bhmd->bhqd', p, v)


def setup_inputs(seed: int = 0) -> dict:
    key = jax.random.key(seed)
    ks = jax.random.split(key, 11)
    f32 = jnp.float32
    x = jax.random.normal(ks[0], (BATCH, SEQ, D_MODEL), f32)
    mem = jax.random.normal(ks[1], (BATCH, N_MEM, D_MODEL), f32)
    w_in = jax.random.normal(ks[2], (DEPTH, D_MODEL, IN_WIDTH), f32) * D_MODEL ** -0.5
    b_forget = 2.0 + 0.5 * jax.random.normal(ks[3], (DEPTH, N_HEADS_FOX), f32)
    w_mem_kv = jax.random.normal(ks[4], (DEPTH, D_MODEL, 2 * W_MEM), f32) * D_MODEL ** -0.5
    w_out = jax.random.normal(ks[5], (DEPTH, MIX_WIDTH, D_MODEL), f32) * MIX_WIDTH ** -0.5
    g_pre = 1.0 + 0.1 * jax.random.normal(ks[6], (DEPTH, D_MODEL), f32)
    g_post = 1.0 + 0.1 * jax.random.normal(ks[7], (DEPTH, D_MODEL), f32)
    g_mem = 1.0 + 0.1 * jax.random.normal(ks[8], (DEPTH, D_MODEL), f32)
    rel_bias = 0.5 * jax.random.normal(ks[9], (N_HEADS_MOBA, T5_BUCKETS), f32)
    return {"x": x, "mem": mem, "w_in": w_in, "b_forget": b_forget, "w_mem_kv": w_mem_kv,
            "w_out": w_out, "g_pre": g_pre, "g_post": g_post, "g_mem": g_mem,
            "rel_bias": rel_bias}


def reference(x, mem, w_in, b_forget, w_mem_kv, w_out, g_pre, g_post, g_mem, rel_bias):
    for layer in range(DEPTH):
        h = rms_norm(x, g_pre[layer])
        proj = jnp.einsum('bsd,de->bse', h, w_in[layer])
        qa, ka, va, ga, qb, kb, vb, gb, fb, qm, gm = jnp.split(proj, in_splits(), axis=-1)
        out_a = moba_attention(split_heads(qa, N_HEADS_MOBA), split_heads(ka, N_HEADS_MOBA),
                               split_heads(va, N_HEADS_MOBA), rel_bias)
        log_f = jax.nn.log_sigmoid((fb + b_forget[layer]).astype(jnp.float32)).transpose(0, 2, 1)
        out_b = forgetting_attention(split_heads(qb, N_HEADS_FOX), split_heads(kb, N_HEADS_FOX),
                                     split_heads(vb, N_HEADS_FOX), log_f)
        mkv = jnp.einsum('bmd,de->bme', rms_norm(mem, g_mem[layer]), w_mem_kv[layer])
        km, vm = jnp.split(mkv, 2, axis=-1)
        out_m = memory_attention(split_heads(qm, N_HEADS_MEM), split_heads(km, N_HEADS_MEM),
                                 split_heads(vm, N_HEADS_MEM))
        y = jnp.concatenate([merge_heads(out_a) * jax.nn.silu(ga),
                             merge_heads(out_b) * jax.nn.silu(gb),
                             merge_heads(out_m) * jax.nn.silu(gm)], axis=-1)
        o = jnp.einsum('bse,ed->bsd', y, w_out[layer])
        x = x + rms_norm(o, g_post[layer])
    return x
```

```cpp
#include <hip/hip_runtime.h>
#include <cstdio>
#include <cstdint>
#include <cmath>

#define LAS __attribute__((address_space(3)))
#define GAS __attribute__((address_space(1)))
typedef unsigned short f16_t;
typedef short hx8 __attribute__((ext_vector_type(8)));
typedef short s16x4 __attribute__((ext_vector_type(4)));
typedef _Float16 h8 __attribute__((ext_vector_type(8)));
typedef _Float16 h2 __attribute__((ext_vector_type(2)));
typedef float f32x2 __attribute__((ext_vector_type(2)));
typedef float f32x4 __attribute__((ext_vector_type(4)));
typedef float f32x16 __attribute__((ext_vector_type(16)));
typedef unsigned u32x2 __attribute__((ext_vector_type(2)));
typedef unsigned u32x4 __attribute__((ext_vector_type(4)));
typedef GAS unsigned gu32;
#define RLX_AGENT __ATOMIC_RELAXED, __HIP_MEMORY_SCOPE_AGENT
#define LDS_WAIT() asm volatile("s_waitcnt lgkmcnt(0)" ::: "memory")
#define VM_WAIT() asm volatile("s_waitcnt vmcnt(0)" ::: "memory")
__device__ __forceinline__ unsigned pkh(float lo, float hi) { const f32x2 v = {lo, hi}; const h2 h = __builtin_convertvector(v, h2); return __builtin_bit_cast(unsigned, h); }

constexpr int DM = 2048, NBATCH = 4, SEQ = 2048, MTOK = NBATCH * SEQ, NMEM = 256, MMEM = NBATCH * NMEM;
constexpr int INW = 7174;
constexpr int N1 = 7168;
constexpr int FB_COL = 6144;
constexpr int NMKV = 1024;
constexpr float RMS_EPS = 1e-6f;
constexpr int NWAVES = 8;
constexpr size_t SLOT_ELEMS = (size_t)MTOK * 128, MKV_SLOT_ELEMS = (size_t)MMEM * 128;

constexpr size_t MiB = 1u << 20;
constexpr size_t WS_CTL = 0, CTL_ZERO_BYTES = 1 * MiB;
constexpr size_t WS_W1T = 2 * MiB;
constexpr size_t WS_W2T = 34 * MiB;
constexpr size_t WS_H = 42 * MiB;
constexpr size_t WS_P = 78 * MiB;
constexpr size_t WS_MKV = 190 * MiB;
constexpr size_t WS_Y = 192 * MiB;
constexpr size_t WS_LF = 224 * MiB;
constexpr size_t WS_NC = WS_LF + 256 * 1024;
constexpr size_t WS_HBP = 225 * MiB;
constexpr size_t WS_KMP = 227 * MiB;
constexpr size_t WS_O32 = WS_P;
constexpr size_t WS_END = 228 * MiB;
constexpr int CW_TMO = 0, CW_CODE = 1, CW_BAR = 4096;

constexpr int RING_BYTES = 150528;
constexpr int LDSCTL_OFF = RING_BYTES, MISC_OFF = LDSCTL_OFF + 320;
constexpr int LDS_BYTES = LDSCTL_OFF + 512;
#define MK_N_LAUNCHES 5
namespace pg8 {
constexpr int BM = 256, BK = 64, HALF = 128, HTB = HALF * BK * 2  , STAGE_BYTES = 8 * HTB, NXCD = 8, WGM = 8;

__host__ __device__ __forceinline__ int lds_byte(int r, int c) { const int st = (r >> 4) * 2 + (c >> 5), rr = r & 15, cc = c & 31, ob = rr * 64 + cc * 2; return st * 1024 + (ob ^ (((ob >> 9) & 1) << 5)); }
__host__ __device__ __forceinline__ void stage_rc(int b, int& R, int& C) { const int st = b / 1024, sb = b % 1024, swz = sb ^ (((sb >> 9) & 1) << 5); R = (st >> 1) * 16 + swz / 64; C = (st & 1) * 32 + (swz % 64) / 2; }
__host__ __device__ __forceinline__ int perm32(int rho) { const int n = rho >> 4, i = rho & 15; return 8 * (i >> 2) + 4 * n + (i & 3); }

struct Unit { int pm, pn; };
struct Gemm { const f16_t* A; const f16_t* Bt; int K; };


template <class Epi, class Sched, bool ALIGN_EPI = false>
__device__ __forceinline__ void gemm_phase(LAS unsigned char* lds, const Gemm g, const Sched& S, const Epi& E) {
    const int tid = threadIdx.x, wid = __builtin_amdgcn_readfirstlane(tid >> 6), lane = tid & 63, wr = wid >> 2, wc = wid & 3, fr = lane & 15, fq = lane >> 4;
    const int K = g.K, nt = K / BK;
    unsigned voffA[2], voffB[2];
#pragma unroll
    for (int i = 0; i < 2; ++i) { int R, C; stage_rc(tid * 16 + i * 8192, R, C); const int Rb = Epi::PERM ? ((R & ~31) + perm32(R & 31)) : R;
        voffA[i] = (unsigned)(R * K + C) * 2u; voffB[i] = (unsigned)(Rb * K + C) * 2u; }
    const size_t kstep = (size_t)(BK * 2);
    const size_t hstep = (size_t)HALF * K * 2;
    const size_t tstep = 2 * hstep;
    const unsigned ldsw = (unsigned)wid * 1024u;
    const int aoff = lds_byte(wr * 64 + fr, fq * 8), boff = lds_byte(wc * 32 + fr, fq * 8);
#define PG8_SA(b, h) (((b) * 2 + (h)) * HTB)
#define PG8_SB(b, h) ((4 + (b) * 2 + (h)) * HTB)
#define PG8_STAGE(bufoff, gbase, voff) do { _Pragma("unroll") for (int _i = 0; _i < 2; ++_i) \
        __builtin_amdgcn_global_load_lds((const unsigned*)((const char*)(gbase) + (voff)[_i]), (LAS unsigned*)(lds + (bufoff) + ldsw + _i * 8192), 16, 0, 0); } while (0)
#define PG8_LDA(dst, b, h) do { _Pragma("unroll") for (int m = 0; m < 4; ++m) _Pragma("unroll") for (int k = 0; k < 2; ++k) dst[m][k] = *(const LAS hx8*)(lds + PG8_SA(b, h) + aoff + m * 2048 + k * 1024); } while (0)
#define PG8_LDB(dst, b, h) do { _Pragma("unroll") for (int n = 0; n < 2; ++n) _Pragma("unroll") for (int k = 0; k < 2; ++k) dst[n][k] = *(const LAS hx8*)(lds + PG8_SB(b, h) + boff + n * 2048 + k * 1024); } while (0)
#define PG8_MMA(ai, bj, At, Bt) do { __builtin_amdgcn_s_setprio(1); _Pragma("unroll") for (int m = 0; m < 4; ++m) _Pragma("unroll") for (int n = 0; n < 2; ++n) _Pragma("unroll") for (int k = 0; k < 2; ++k) \
        acc[ai][bj][m][n] = __builtin_amdgcn_mfma_f32_16x16x32_f16(__builtin_bit_cast(h8, Bt[n][k]), __builtin_bit_cast(h8, At[m][k]), acc[ai][bj][m][n], 0, 0, 0); __builtin_amdgcn_s_setprio(0); } while (0)
#define PG8_WAIT_V(n) asm volatile("s_waitcnt vmcnt(" #n ")" ::: "memory")
#define PG8_WAIT_L(n) asm volatile("s_waitcnt lgkmcnt(" #n ")" ::: "memory")
#define PG8_BAR __builtin_amdgcn_s_barrier()
#define PG8_SCHED __builtin_amdgcn_sched_barrier(0)
    Unit cur, nxt; int ui = 0;
    if (!S.next(0, cur)) return;
    f32x4 acc[2][2][4][2];
#pragma unroll
    for (int a = 0; a < 2; ++a)
#pragma unroll
        for (int b = 0; b < 2; ++b)
#pragma unroll
            for (int m = 0; m < 4; ++m)
#pragma unroll
                for (int n = 0; n < 2; ++n) acc[a][b][m][n] = (f32x4){0.f, 0.f, 0.f, 0.f};
    hx8 At[4][2], B0[2][2], B1[2][2];
    const char* cA = (const char*)g.A + (size_t)cur.pm * tstep; const char* cB = (const char*)g.Bt + (size_t)cur.pn * tstep;
    PG8_STAGE(PG8_SB(0, 0), cB, voffB); PG8_STAGE(PG8_SB(0, 1), cB + hstep, voffB); PG8_STAGE(PG8_SA(0, 0), cA, voffA); PG8_STAGE(PG8_SA(0, 1), cA + hstep, voffA);
    if (wr == 1) PG8_BAR;
    PG8_WAIT_V(2); PG8_BAR;
    PG8_STAGE(PG8_SB(1, 0), cB + kstep, voffB); PG8_STAGE(PG8_SA(1, 0), cA + kstep, voffA); PG8_STAGE(PG8_SB(1, 1), cB + hstep + kstep, voffB);
    PG8_WAIT_V(6); PG8_BAR;
    for (;;) {
        const bool has_next = S.next(ui + 1, nxt);
        const char* nA = has_next ? (const char*)g.A + (size_t)nxt.pm * tstep : cA; const char* nB = has_next ? (const char*)g.Bt + (size_t)nxt.pn * tstep : cB;
        for (int t = 0; t < nt; t += 2) {
            const bool last = (t == nt - 2);
            const char* a1 = cA + (size_t)(t + 1) * kstep;
            const char* a2 = last ? nA : cA + (size_t)(t + 2) * kstep; const char* b2 = last ? nB : cB + (size_t)(t + 2) * kstep;
            const char* a3 = a2 + kstep; const char* b3 = b2 + kstep;
            PG8_LDB(B0, 0, 0); PG8_LDB(B1, 0, 1); PG8_SCHED; PG8_LDA(At, 0, 0); PG8_STAGE(PG8_SA(1, 1), a1 + hstep, voffA);
            PG8_WAIT_V(8); PG8_WAIT_L(0); PG8_BAR; PG8_MMA(0, 0, At, B0); PG8_MMA(0, 1, At, B1); PG8_BAR; PG8_SCHED;
            PG8_LDA(At, 0, 1); PG8_STAGE(PG8_SB(0, 0), b2, voffB); PG8_STAGE(PG8_SB(0, 1), b2 + hstep, voffB); PG8_STAGE(PG8_SA(0, 0), a2, voffA);
            PG8_WAIT_V(8); PG8_WAIT_L(0); PG8_BAR; PG8_MMA(1, 0, At, B0); PG8_MMA(1, 1, At, B1); PG8_BAR; PG8_SCHED;
            PG8_LDB(B0, 1, 0); PG8_LDB(B1, 1, 1); PG8_SCHED; PG8_LDA(At, 1, 0); PG8_STAGE(PG8_SA(0, 1), a2 + hstep, voffA);
            PG8_WAIT_V(8); PG8_WAIT_L(0); PG8_BAR; PG8_MMA(0, 0, At, B0); PG8_MMA(0, 1, At, B1); PG8_BAR; PG8_SCHED;
            PG8_LDA(At, 1, 1); PG8_STAGE(PG8_SB(1, 0), b3, voffB); PG8_STAGE(PG8_SB(1, 1), b3 + hstep, voffB); PG8_STAGE(PG8_SA(1, 0), a3, voffA);
            PG8_WAIT_V(8); PG8_WAIT_L(0); PG8_BAR; PG8_MMA(1, 0, At, B0); PG8_MMA(1, 1, At, B1); PG8_BAR; PG8_SCHED;
        }
        if constexpr (ALIGN_EPI) { if (wr == 0) PG8_BAR; }
        if constexpr (!Epi::AFTER_DRAIN) { E(acc, cur, wr, wc, fr, fq); }
        if (!has_next) break;
#pragma unroll
        for (int a = 0; a < 2; ++a)
#pragma unroll
            for (int b = 0; b < 2; ++b)
#pragma unroll
                for (int m = 0; m < 4; ++m)
#pragma unroll
                    for (int n = 0; n < 2; ++n) acc[a][b][m][n] = (f32x4){0.f, 0.f, 0.f, 0.f};
        cur = nxt; cA = nA; cB = nB; ++ui;
        if constexpr (ALIGN_EPI) { if (wr == 1) PG8_BAR; }
    }
    PG8_WAIT_V(0);
    if constexpr (!ALIGN_EPI) { if (wr == 0) PG8_BAR; }
    PG8_BAR;
    if constexpr (Epi::AFTER_DRAIN) { E.fused(acc, cur, wr, wc, fr, fq, lds, wid, lane); }
#undef PG8_SA
#undef PG8_SB
#undef PG8_STAGE
#undef PG8_LDA
#undef PG8_LDB
#undef PG8_MMA
#undef PG8_WAIT_V
#undef PG8_WAIT_L
#undef PG8_BAR
#undef PG8_SCHED
}
}
namespace att {
constexpr int D = 128, NW = 8, QBLK = 32, KVBLK = 64, QB = NW * QBLK;
constexpr int SHM_V = KVBLK * D * 2, SHM_K = KVBLK * D * 2;
constexpr int LDS_WS = 2 * SHM_V + 2 * SHM_K;
constexpr int LDS_X = LDS_WS + NW * 64 * 4;
constexpr int X_BYTES = 13312;
constexpr int LDS_OST = LDS_X + X_BYTES;
constexpr int OST_ROWB = 272;
constexpr int LDS_END = LDS_OST + NW * 32 * OST_ROWB;
constexpr float SCALE = 0.08838834764831845f;
constexpr float INV_SCALE = 11.313708498984761f;
constexpr float C2 = 1.4426950408889634f * SCALE;
constexpr float THR = 8.f;

#define KSWZ(row, colB) ((row) * 256 + ((colB) ^ (((row) & 7) << 4)))
#define SBAR() __builtin_amdgcn_sched_barrier(0)
__device__ __forceinline__ int v_st(int k, int c) { const int kk = (k & ~0xC) | ((k & 4) << 1) | ((k & 8) >> 1); return ((kk >> 3) * 4 + (c >> 5)) * 512 + ((kk & 7) * 32 + (c & 31)) * 2; }
__device__ __forceinline__ int v_rd_base(int lane) { return ((lane & 3) << 3) | (((lane >> 2) & 3) << 6) | (((lane >> 4) & 1) << 5) | (((lane >> 5) & 1) << 8); }
constexpr int v_rd_off(int d0, int ks, int half) { return d0 * 512 + ks * 4096 + half * 2048; }
__device__ __forceinline__ int crow(int r, int hi) { return (r & 3) + 8 * (r >> 2) + 4 * hi; }

__device__ __forceinline__ int t5_bucket(int n) {
    if (n < 16) return n;
    int v = 16 + (int)(logf((float)n * (1.0f / 16.0f)) * (16.0f / 2.0794415416798357f));
    return v > 31 ? 31 : v;
}

struct BlockRef { const f16_t* Q; const f16_t* K; const f16_t* V; const f16_t* Gt; f16_t* Y; const float* aux; const float* rb; int P0, NT, mode, qb; };
struct Seam { hx8 qr[8]; hx8 st_v0, st_v1, st_k0, st_k1; };

__device__ __forceinline__ void partialSM(f32x16& p0, f32x16& p1, float& m_reg, float& mn, float& alpha, float off) {
    float pmax = p0[0];
#pragma unroll
    for (int r = 1; r < 16; ++r) pmax = fmaxf(pmax, p0[r]);
#pragma unroll
    for (int r = 0; r < 16; ++r) pmax = fmaxf(pmax, p1[r]);
    { auto rr = __builtin_amdgcn_permlane32_swap(__float_as_uint(pmax), __float_as_uint(pmax), false, false);
      pmax = fmaxf(__uint_as_float(rr[0]), __uint_as_float(rr[1])); }
    pmax += off;
    if (__builtin_expect(__all((pmax - m_reg) * SCALE <= THR), 1)) { mn = m_reg; alpha = 1.f; }
    else { mn = fmaxf(m_reg, pmax); alpha = __builtin_amdgcn_exp2f((m_reg - mn) * C2); m_reg = mn; }
    const float mnL = (off - mn) * C2;
#pragma unroll
    for (int r = 0; r < 16; ++r) p0[r] = fmaf(p0[r], C2, mnL);
#pragma unroll
    for (int r = 0; r < 16; ++r) p1[r] = fmaf(p1[r], C2, mnL);
#pragma unroll
    for (int r = 0; r < 16; ++r) p0[r] = __builtin_amdgcn_exp2f(p0[r]);
}
__device__ __forceinline__ void finishSM(f32x16& p0, f32x16& p1, float alpha, float& l_reg, hx8& pa0, hx8& pa1, hx8& pa2, hx8& pa3) {
#pragma unroll
    for (int r = 0; r < 16; ++r) p1[r] = __builtin_amdgcn_exp2f(p1[r]);
    float ps = 0;
#pragma unroll
    for (int r = 0; r < 16; ++r) ps += p0[r];
#pragma unroll
    for (int r = 0; r < 16; ++r) ps += p1[r];
    { auto rr = __builtin_amdgcn_permlane32_swap(__float_as_uint(ps), __float_as_uint(ps), false, false);
      ps = __uint_as_float(rr[0]) + __uint_as_float(rr[1]); }
    l_reg = l_reg * alpha + ps;
#define PK4(P, B_, OUT) do { unsigned a0 = pkh(P[B_+0], P[B_+1]), a1 = pkh(P[B_+2], P[B_+3]);                          \
        unsigned b0 = pkh(P[B_+4], P[B_+5]), b1 = pkh(P[B_+6], P[B_+7]);                                             \
        auto r0 = __builtin_amdgcn_permlane32_swap(a0, b0, false, false); auto r1 = __builtin_amdgcn_permlane32_swap(a1, b1, false, false); \
        u32x4 w = {r0[0], r1[0], r0[1], r1[1]}; OUT = __builtin_bit_cast(hx8, w); } while (0)
    PK4(p0, 0, pa0); PK4(p0, 8, pa1); PK4(p1, 0, pa2); PK4(p1, 8, pa3);
#undef PK4
}
template <int KB>
__device__ __forceinline__ void qkt(f32x16& p0, f32x16& p1, const char* K_lds, int r32, int hi, const hx8* qr) {
    p0 = f32x16{}; p1 = f32x16{};
    const char* kb[4];
#pragma unroll
    for (int dd = 0; dd < 4; ++dd) kb[dd] = K_lds + KB * SHM_K + KSWZ(r32, (dd * 16 + hi * 8) * 2);
#pragma unroll
    for (int d0 = 0; d0 < 8; ++d0) { const char* a = kb[d0 & 3] + (d0 >> 2) * 128;
        hx8 b0 = *reinterpret_cast<const hx8*>(a);
        hx8 b1 = *reinterpret_cast<const hx8*>(a + 32 * 256);
        p0 = __builtin_amdgcn_mfma_f32_32x32x16_f16(__builtin_bit_cast(h8, b0), __builtin_bit_cast(h8, qr[d0]), p0, 0, 0, 0);
        p1 = __builtin_amdgcn_mfma_f32_32x32x16_f16(__builtin_bit_cast(h8, b1), __builtin_bit_cast(h8, qr[d0]), p1, 0, 0, 0); }
}
template <int VB>
__device__ __forceinline__ void pv_tile(f32x16* o, int vb0, hx8 pa0, hx8 pa1, hx8 pa2, hx8 pa3) {
#define TRRD(dst, off) asm volatile("ds_read_b64_tr_b16 %0, %1 offset:%2" : "=&v"(dst) : "v"(vb0), "i"(off) : "memory")
#define HV(l, h) __builtin_bit_cast(h8, (hx8){l[0], l[1], l[2], l[3], h[0], h[1], h[2], h[3]})
#define PV_D0(d0) do { s16x4 l0, l1, l2, l3, h0, h1, h2, h3; constexpr int b_ = VB * SHM_V + v_rd_off(d0, 0, 0);  \
        TRRD(l0, b_); TRRD(h0, b_ + 2048); TRRD(l1, b_ + 4096); TRRD(h1, b_ + 6144); TRRD(l2, b_ + 8192); TRRD(h2, b_ + 10240); TRRD(l3, b_ + 12288); TRRD(h3, b_ + 14336); \
        asm volatile("s_waitcnt lgkmcnt(0)" ::: "memory"); SBAR();             \
        o[d0] = __builtin_amdgcn_mfma_f32_32x32x16_f16(__builtin_bit_cast(h8, pa0), HV(l0, h0), o[d0], 0, 0, 0);   \
        o[d0] = __builtin_amdgcn_mfma_f32_32x32x16_f16(__builtin_bit_cast(h8, pa1), HV(l1, h1), o[d0], 0, 0, 0);   \
        o[d0] = __builtin_amdgcn_mfma_f32_32x32x16_f16(__builtin_bit_cast(h8, pa2), HV(l2, h2), o[d0], 0, 0, 0);   \
        o[d0] = __builtin_amdgcn_mfma_f32_32x32x16_f16(__builtin_bit_cast(h8, pa3), HV(l3, h3), o[d0], 0, 0, 0); } while (0)
    PV_D0(0); PV_D0(1); PV_D0(2); PV_D0(3);
#undef PV_D0
#undef HV
#undef TRRD
}

__device__ __forceinline__ float attn_modify(f32x16& p0, f32x16& p1, int mode, int t, int qb, int qlo, int qm, int hi, unsigned selmask, float rb31,
                                             const LAS float* XT, const LAS float* XNC) {
    const float NEG = -__builtin_inff();
    const int kb = t * KVBLK; float off = 0.f;
    if (mode == 0) {
        const int n = t >> 2;
        if (n != qb) off = ((selmask >> n) & 1u) ? 0.f : NEG;
        if (kb + 191 > qlo) {
            const int dq = qm - kb;
#pragma unroll
            for (int r = 0; r < 16; ++r) {
                const int c = (r & 3) + 8 * (r >> 2);
                const int d0 = dq - c, d1 = dq - c - 32;
                unsigned i0 = (unsigned)d0; i0 = i0 > 128u ? 128u : i0;
                unsigned i1 = (unsigned)d1; i1 = i1 > 128u ? 128u : i1;
                const float b0 = XT[i0], b1 = XT[i1];
                p0[r] = d0 < 0 ? NEG : p0[r] + b0;
                p1[r] = d1 < 0 ? NEG : p1[r] + b1;
                if ((r & 3) == 3) SBAR();
            }
        } else off += rb31;
    } else if (mode == 1) {
        const LAS float* nc = XNC + kb + 4 * hi;
#pragma unroll
        for (int j = 0; j < 4; ++j) {
            const f32x4 a = *(const LAS f32x4*)(nc + 8 * j), b = *(const LAS f32x4*)(nc + 8 * j + 32);
#pragma unroll
            for (int e = 0; e < 4; ++e) { p0[4 * j + e] += a[e]; p1[4 * j + e] += b[e]; }
            SBAR();
        }
        if (kb + KVBLK - 1 > qlo) {
            const int dq = qm - kb;
#pragma unroll
            for (int r = 0; r < 16; ++r) {
                const int c = (r & 3) + 8 * (r >> 2);
                if (dq - c < 0) p0[r] = NEG;
                if (dq - c - 32 < 0) p1[r] = NEG;
            }
        }
    }
    return off;
}

#define ROW(p, k0, rr) ((p) + (size_t)((k0) + (rr)) * D + sc)
#define VMW() asm volatile("s_waitcnt vmcnt(0)" ::: "memory")
#define VMWN(n) asm volatile("s_waitcnt vmcnt(%0)" :: "i"(n) : "memory")
#define LD8(p) (*reinterpret_cast<const hx8*>(p))
#define SLOAD_H(Kp, Vp, k0) do { S.st_v0 = LD8(ROW(Vp, k0, sr)); S.st_v1 = LD8(ROW(Vp, k0, 32 + sr));              \
                         S.st_k0 = LD8(ROW(Kp, k0, sr)); S.st_k1 = LD8(ROW(Kp, k0, 32 + sr)); } while (0)
#define SWRITE_HK(bf) do { *(hx8*)(K_lds + (bf) * SHM_K + kws) = S.st_k0; *(hx8*)(K_lds + (bf) * SHM_K + kws + 32 * 256) = S.st_k1; } while (0)
#define SWRITE_HV(bf) do { *(hx8*)(V_lds + (bf) * SHM_V + vst0) = S.st_v0; *(hx8*)(V_lds + (bf) * SHM_V + vst1) = S.st_v1; } while (0)
#define SWRITE_H(bf) do { SWRITE_HV(bf); SWRITE_HK(bf); } while (0)

__device__ __forceinline__ void attn_prime(const BlockRef& cur, char* lds, Seam& S) {
    const int tid = threadIdx.x, wid = __builtin_amdgcn_readfirstlane(tid >> 6), lane = tid & 63, r32 = lane & 31, hi = lane >> 5;
    const int sr = tid >> 4, sc = (tid & 15) * 8, kws = KSWZ(sr, sc * 2); char* K_lds = lds + 2 * SHM_V;
#pragma unroll
    for (int d0 = 0; d0 < 8; ++d0) S.qr[d0] = LD8(cur.Q + (size_t)(wid * QBLK + r32) * D + d0 * 16 + hi * 8);
    SLOAD_H(cur.K, cur.V, 0); VMW(); SWRITE_HK(0);
    __syncthreads();
}

__device__ __forceinline__ void attn_block(const BlockRef& cur, const BlockRef& nxt, char* lds, Seam& S) {
    const int tid = threadIdx.x, wid = __builtin_amdgcn_readfirstlane(tid >> 6), lane = tid & 63, r32 = lane & 31, hi = lane >> 5;
    const int NT = cur.NT, mode = cur.mode, qb = cur.qb;
    const int qlo = cur.P0 + wid * QBLK, qm = qlo + r32 - 4 * hi;
    char* V_lds = lds; char* K_lds = lds + 2 * SHM_V;
    float* ws = (float*)(lds + LDS_WS) + wid * 64; float* li_l = ws, * al_l = ws + 32;
    LAS float* XT = (LAS float*)(LAS char*)(lds + LDS_X); LAS float* XKML = XT + 256; LAS float* XNC = XT + 1152;
    float m_reg = -1e30f, l_reg = 0; f32x16 o[4] = {};
    const int sr = tid >> 4, sc = (tid & 15) * 8, vst0 = v_st(sr, sc), vst1 = v_st(32 + sr, sc), kws = KSWZ(sr, sc * 2);
    const int vb0 = (int)(uintptr_t)V_lds + v_rd_base(lane);
    const f16_t* Kh = cur.K; const f16_t* Vh = cur.V;
    unsigned selmask = 0u; float rb31 = 0.f;
    int te = tid; asm volatile("" : "+v"(te));
    if (mode == 0) {
        if (te <= 128) XT[te] = cur.rb[t5_bucket(te)] * INV_SCALE;
        for (int idx = te; idx < qb * 128; idx += 512) { const int n = idx >> 7, d = idx & 127; float s = 0.f;
#pragma unroll
            for (int kc = 0; kc < 8; ++kc) s += cur.aux[kc * (32 * 768) + n * 768 + d];
            XKML[idx] = s; }
        __syncthreads();
        rb31 = XT[128];
        float g[7];
#pragma unroll
        for (int n = 0; n < 7; ++n) {
            float a = 0.f;
            if (n < qb) {
#pragma unroll
                for (int d0 = 0; d0 < 8; ++d0) {
                    const f32x4 k0 = *(const LAS f32x4*)(XKML + n * 128 + d0 * 16 + hi * 8), k1 = *(const LAS f32x4*)(XKML + n * 128 + d0 * 16 + hi * 8 + 4);
                    const h8 q = __builtin_bit_cast(h8, S.qr[d0]);
                    a += (float)q[0] * k0[0] + (float)q[1] * k0[1] + (float)q[2] * k0[2] + (float)q[3] * k0[3]
                       + (float)q[4] * k1[0] + (float)q[5] * k1[1] + (float)q[6] * k1[2] + (float)q[7] * k1[3];
                }
                auto rr = __builtin_amdgcn_permlane32_swap(__float_as_uint(a), __float_as_uint(a), false, false);
                a = __uint_as_float(rr[0]) + __uint_as_float(rr[1]);
            }
            g[n] = (n < qb) ? a : -__builtin_inff();
        }
#pragma unroll
        for (int pick = 0; pick < 3; ++pick) {
            float best = -__builtin_inff(); int bi = -1;
#pragma unroll
            for (int n = 0; n < 7; ++n) { const bool free_ = ((selmask >> n) & 1u) == 0u; if (free_ && g[n] > best) { best = g[n]; bi = n; } }
            if (bi >= 0) selmask |= 1u << bi;
        }
    } else if (mode == 1) {
        const int n4 = (cur.P0 + QB) >> 2;
        for (int idx = te; idx < n4; idx += 512) ((LAS f32x4*)XNC)[idx] = ((const f32x4*)cur.aux)[idx];
        __syncthreads();
    }
#define RESC(a) do { if (__any((a) < 1.f)) { if (hi == 0) al_l[r32] = (a); asm volatile("s_waitcnt lgkmcnt(0)" ::: "memory");              \
                     _Pragma("unroll") for (int d_ = 0; d_ < 4; ++d_) _Pragma("unroll") for (int r = 0; r < 16; ++r) o[d_][r] *= al_l[crow(r, hi)]; } } while (0)
#define KBASE(t) ((t) * KVBLK)
#define MODSM(PX0, PX1, mnX, alX, t) do { const float off_ = attn_modify(PX0, PX1, mode, (t), qb, qlo, qm, hi, selmask, rb31, XT, XNC); partialSM(PX0, PX1, m_reg, mnX, alX, off_); } while (0)
    constexpr int NQL = 8;
#define SEAM_K0() do { VMWN(NQL); SWRITE_HK(0); SBAR(); } while (0)
    f32x16 pA0, pA1, pB0, pB1; float mnA, mnB, alA, alB; hx8 pa0, pa1, pa2, pa3;
    SWRITE_HV(0); SBAR();
    if (NT > 1) { SLOAD_H(Kh, Vh, KBASE(1)); }
    SBAR(); qkt<0>(pA0, pA1, K_lds, r32, hi, S.qr);
    MODSM(pA0, pA1, mnA, alA, 0);
    if (NT > 1) { VMW(); SWRITE_H(1); }
    __syncthreads();
#define HALF_STEP(PX0, PX1, mnX, alX, PY0, PY1, alY, t, KB, VB, SB) do {                                                      \
        SBAR(); qkt<KB>(PX0, PX1, K_lds, r32, hi, S.qr);                                                                      \
        finishSM(PY0, PY1, alY, l_reg, pa0, pa1, pa2, pa3); SBAR();                                                           \
        if ((t) + 1 < NT) { SLOAD_H(Kh, Vh, KBASE((t) + 1)); SBAR(); }                                                        \
        pv_tile<VB>(o, vb0, pa0, pa1, pa2, pa3); MODSM(PX0, PX1, mnX, alX, (t));                                             \
        __syncthreads();                                                                                                      \
        if ((t) + 1 < NT) { VMW(); SWRITE_H(SB); }                                                                            \
        RESC(alX); __syncthreads(); } while (0)
    for (int t = 1; t + 1 < NT; t += 2) {
        HALF_STEP(pB0, pB1, mnB, alB, pA0, pA1, alA, t, 1, 0, 0);
        HALF_STEP(pA0, pA1, mnA, alA, pB0, pB1, alB, t + 1, 0, 1, 1);
    }
    const bool even = (NT & 1) == 0;
    if (even) { SBAR(); qkt<1>(pB0, pB1, K_lds, r32, hi, S.qr); SBAR(); }
    { SLOAD_H(nxt.K, nxt.V, 0); SBAR();
#pragma unroll
      for (int d0 = 0; d0 < 8; ++d0) S.qr[d0] = LD8(nxt.Q + (size_t)(wid * QBLK + r32) * D + d0 * 16 + hi * 8); }
    SBAR();
    finishSM(pA0, pA1, alA, l_reg, pa0, pa1, pa2, pa3); SBAR();
    pv_tile<0>(o, vb0, pa0, pa1, pa2, pa3);
    if (even) { MODSM(pB0, pB1, mnB, alB, NT - 1); __syncthreads(); RESC(alB);
        finishSM(pB0, pB1, alB, l_reg, pa0, pa1, pa2, pa3); SBAR(); pv_tile<1>(o, vb0, pa0, pa1, pa2, pa3); }
    SBAR(); SEAM_K0();
    if (hi == 0) li_l[r32] = l_reg; asm volatile("s_waitcnt lgkmcnt(0)" ::: "memory");
    {
        int le = lane; asm volatile("" : "+v"(le));
        const int r32e = le & 31, hie = le >> 5, rowe = le >> 4, che = le & 15;
        LAS unsigned char* stg = (LAS unsigned char*)(LAS char*)(lds + LDS_OST) + wid * (32 * OST_ROWB);
        LAS unsigned char* stw = stg + (4 * hie) * OST_ROWB + r32e * 2;
#pragma unroll
        for (int r = 0; r < 16; ++r) { const int orc = (r & 3) + 8 * (r >> 2); const float rl = __builtin_amdgcn_rcpf(li_l[orc + 4 * hie]);
#pragma unroll
            for (int d0 = 0; d0 < 4; ++d0) *(LAS _Float16*)(stw + orc * OST_ROWB + d0 * 64) = (_Float16)(o[d0][r] * rl); }
        asm volatile("s_waitcnt lgkmcnt(0)" ::: "memory");
        const f16_t* Gw = cur.Gt + (size_t)(wid * QBLK + rowe) * D + che * 8; f16_t* Yw = cur.Y + (size_t)(wid * QBLK + rowe) * 2048 + che * 8;
        const LAS unsigned char* str = stg + rowe * OST_ROWB + che * 16;
#pragma unroll
        for (int i = 0; i < 8; ++i) {
            const h8 ov = *(const LAS h8*)(str + i * 4 * OST_ROWB);
            const h8 gv = __builtin_bit_cast(h8, LD8(Gw + (size_t)(i * 4) * D));
            float y[8];
#pragma unroll
            for (int e = 0; e < 8; ++e) { const float gg = (float)gv[e]; const float sg = __builtin_amdgcn_rcpf(1.0f + __builtin_amdgcn_exp2f(-1.4426950408889634f * gg)); y[e] = (float)ov[e] * gg * sg; }
            u32x4 w = {pkh(y[0], y[1]), pkh(y[2], y[3]), pkh(y[4], y[5]), pkh(y[6], y[7])};
            *(u32x4*)(Yw + (size_t)(i * 4) * 2048) = w; }
    }
    __syncthreads();
#undef RESC
#undef KBASE
#undef MODSM
#undef SEAM_K0
#undef HALF_STEP
}
#undef ROW
#undef VMW
#undef VMWN
#undef LD8
#undef SLOAD_H
#undef SWRITE_HK
#undef SWRITE_HV
#undef SWRITE_H
#undef KSWZ
#undef SBAR
}
constexpr int ATT_MAXU = 3;
__device__ const short att_sched[256][ATT_MAXU] = {
  {7,-1,-1},
  {15,-1,-1},
  {23,-1,-1},
  {31,-1,-1},
  {39,-1,-1},
  {47,-1,-1},
  {55,-1,-1},
  {63,-1,-1},
  {71,-1,-1},
  {79,-1,-1},
  {87,-1,-1},
  {95,-1,-1},
  {103,-1,-1},
  {111,-1,-1},
  {119,-1,-1},
  {127,-1,-1},
  {135,-1,-1},
  {143,-1,-1},
  {151,-1,-1},
  {159,-1,-1},
  {167,-1,-1},
  {175,-1,-1},
  {183,-1,-1},
  {191,-1,-1},
  {199,-1,-1},
  {207,-1,-1},
  {215,-1,-1},
  {223,-1,-1},
  {231,-1,-1},
  {239,-1,-1},
  {247,-1,-1},
  {255,-1,-1},
  {263,-1,-1},
  {271,-1,-1},
  {279,-1,-1},
  {287,-1,-1},
  {295,-1,-1},
  {303,-1,-1},
  {311,-1,-1},
  {319,-1,-1},
  {327,-1,-1},
  {335,-1,-1},
  {343,-1,-1},
  {351,-1,-1},
  {359,-1,-1},
  {367,-1,-1},
  {375,-1,-1},
  {383,-1,-1},
  {6,-1,-1},
  {14,-1,-1},
  {22,-1,-1},
  {30,-1,-1},
  {38,-1,-1},
  {46,-1,-1},
  {54,-1,-1},
  {62,-1,-1},
  {70,-1,-1},
  {78,-1,-1},
  {86,-1,-1},
  {94,-1,-1},
  {102,-1,-1},
  {110,-1,-1},
  {118,-1,-1},
  {126,-1,-1},
  {134,-1,-1},
  {142,-1,-1},
  {150,-1,-1},
  {158,-1,-1},
  {166,-1,-1},
  {174,-1,-1},
  {182,-1,-1},
  {190,-1,-1},
  {198,496,-1},
  {206,497,-1},
  {214,498,-1},
  {222,499,-1},
  {230,500,-1},
  {238,501,-1},
  {246,502,-1},
  {254,503,-1},
  {262,504,-1},
  {270,505,-1},
  {278,506,-1},
  {286,507,-1},
  {294,508,-1},
  {302,509,-1},
  {310,510,-1},
  {318,511,-1},
  {326,-1,-1},
  {334,-1,-1},
  {342,-1,-1},
  {350,-1,-1},
  {358,-1,-1},
  {366,-1,-1},
  {374,-1,-1},
  {382,-1,-1},
  {5,392,-1},
  {13,393,-1},
  {21,394,-1},
  {29,395,-1},
  {37,396,-1},
  {45,397,-1},
  {53,398,-1},
  {61,399,-1},
  {69,400,-1},
  {77,401,-1},
  {85,402,-1},
  {93,403,-1},
  {101,404,-1},
  {109,405,-1},
  {117,406,-1},
  {125,407,-1},
  {133,408,-1},
  {141,409,-1},
  {149,410,-1},
  {157,411,-1},
  {165,412,-1},
  {173,413,-1},
  {181,414,-1},
  {189,415,-1},
  {197,256,-1},
  {205,264,-1},
  {213,272,-1},
  {221,280,-1},
  {229,288,-1},
  {237,296,-1},
  {245,304,-1},
  {253,312,-1},
  {261,320,-1},
  {269,328,-1},
  {277,336,-1},
  {285,344,-1},
  {293,352,-1},
  {301,360,-1},
  {309,368,-1},
  {317,376,-1},
  {325,384,-1},
  {333,385,-1},
  {341,386,-1},
  {349,387,-1},
  {357,388,-1},
  {365,389,-1},
  {373,390,-1},
  {381,391,-1},
  {4,64,464},
  {12,72,465},
  {20,80,466},
  {28,88,467},
  {36,96,468},
  {44,104,469},
  {52,112,470},
  {60,120,471},
  {68,128,472},
  {76,136,473},
  {84,144,474},
  {92,152,475},
  {100,160,476},
  {108,168,477},
  {116,176,478},
  {124,184,479},
  {132,192,440},
  {140,200,441},
  {148,208,442},
  {156,216,443},
  {164,224,444},
  {172,232,445},
  {180,240,446},
  {188,248,447},
  {196,257,-1},
  {204,265,-1},
  {212,273,-1},
  {220,281,-1},
  {228,289,-1},
  {236,297,-1},
  {244,305,-1},
  {252,313,-1},
  {260,321,-1},
  {268,329,-1},
  {276,337,-1},
  {284,345,-1},
  {292,353,-1},
  {300,361,-1},
  {308,369,-1},
  {316,377,-1},
  {324,0,416},
  {332,8,417},
  {340,16,418},
  {348,24,419},
  {356,32,420},
  {364,40,421},
  {372,48,422},
  {380,56,423},
  {3,65,480},
  {11,73,481},
  {19,81,482},
  {27,89,483},
  {35,97,484},
  {43,105,485},
  {51,113,486},
  {59,121,487},
  {67,129,488},
  {75,137,489},
  {83,145,490},
  {91,153,491},
  {99,161,492},
  {107,169,493},
  {115,177,494},
  {123,185,495},
  {131,193,448},
  {139,201,449},
  {147,209,450},
  {155,217,451},
  {163,225,452},
  {171,233,453},
  {179,241,454},
  {187,249,455},
  {195,258,-1},
  {203,266,-1},
  {211,274,-1},
  {219,282,-1},
  {227,290,-1},
  {235,298,-1},
  {243,306,-1},
  {251,314,-1},
  {259,322,-1},
  {267,330,-1},
  {275,338,-1},
  {283,346,-1},
  {291,354,-1},
  {299,362,-1},
  {307,370,-1},
  {315,378,-1},
  {323,1,424},
  {331,9,425},
  {339,17,426},
  {347,25,427},
  {355,33,428},
  {363,41,429},
  {371,49,430},
  {379,57,431},
  {2,130,456},
  {10,138,457},
  {18,146,458},
  {26,154,459},
  {34,162,460},
  {42,170,461},
  {50,178,462},
  {58,186,463},
  {66,194,432},
  {74,202,433},
  {82,210,434},
  {90,218,435},
  {98,226,436},
  {106,234,437},
  {114,242,438},
  {122,250,439},
};
#define XB_TMO      128
#define XB_XCNT(j)  (256  + 64 * (j))
#define XB_XSUB(j)  (1280 + 64 * (j))
#define XB_XGEN(j)  (2304 + 64 * (j))
#define XB_TOP      3328
#define XB_TOPGEN   3392
#define XCD_BAR_WORDS 3456
#define XB_SPIN_CAP (1u << 18)

__device__ __forceinline__ unsigned xb_ld(unsigned* p)              { return __hip_atomic_load(p, __ATOMIC_RELAXED, __HIP_MEMORY_SCOPE_AGENT); }
__device__ __forceinline__ unsigned xb_add(unsigned* p, unsigned v) { return __hip_atomic_fetch_add(p, v, __ATOMIC_RELAXED, __HIP_MEMORY_SCOPE_AGENT); }
__device__ __forceinline__ unsigned xb_xcc_id() { return (unsigned)__builtin_amdgcn_s_getreg((3 << 11) | 20) & 0xFu; }
#define XB_SPIN(cond, bar) do { unsigned _sp = 0; while (cond) { __builtin_amdgcn_s_sleep(1); \
    if ((++_sp & 255u) == 0u) { if (xb_ld(&(bar)[XB_TMO])) break; if (_sp > XB_SPIN_CAP) { atomicAdd(&(bar)[XB_TMO], 1u); break; } } } } while (0)

struct XcdBarrier {
    unsigned* bar; unsigned x;
    volatile LAS unsigned* st;
};
__device__ __forceinline__ XcdBarrier xcd_barrier_post(unsigned* bar, volatile LAS unsigned* st) {
    XcdBarrier b; b.bar = bar; b.x = xb_xcc_id(); b.st = st;
    if (threadIdx.x == 0) (void)xb_add(&bar[XB_XCNT(b.x)], 1u);
    return b;
}
__device__ __forceinline__ void xcd_barrier_complete(unsigned* bar, unsigned x, unsigned& nloc, unsigned& nx) {
    const unsigned G = gridDim.x * gridDim.y * gridDim.z;
    unsigned sum, cnt, mine, sp = 0u;
    for (;;) {
        sum = 0u; cnt = 0u; mine = 0u;
#pragma unroll
        for (unsigned j = 0; j < 16; ++j) { const unsigned c = xb_ld(&bar[XB_XCNT(j)]); sum += c; cnt += (c > 0u) ? 1u : 0u; mine = (j == x) ? c : mine; }
        if (sum == G) break;
        __builtin_amdgcn_s_sleep(1);
        if ((++sp & 255u) == 0u) { if (xb_ld(&bar[XB_TMO])) break; if (sp > XB_SPIN_CAP) { atomicAdd(&bar[XB_TMO], 1u); break; } }
    }
    nloc = mine > 0u ? mine : 1u; nx = cnt > 0u ? cnt : 1u;
}
__device__ __forceinline__ void xcd_barrier(const XcdBarrier& b) {
    asm volatile("s_waitcnt vmcnt(0)" ::: "memory");
    __syncthreads();
    if (threadIdx.x == 0) {
        unsigned* bar = b.bar;
        __builtin_amdgcn_s_waitcnt(0);
        unsigned nloc = b.st[0], nx = b.st[1];
        if (nloc == 0u) { xcd_barrier_complete(bar, b.x, nloc, nx); b.st[0] = nloc; b.st[1] = nx; }
        const unsigned old = xb_add(&bar[XB_XSUB(b.x)], 1u);
        const unsigned gen = old / nloc;
        if (old + 1u == (gen + 1u) * nloc) {
            __builtin_amdgcn_fence(__ATOMIC_RELEASE, "agent");
            asm volatile("s_waitcnt vmcnt(0)" ::: "memory");
            const unsigned og = xb_add(&bar[XB_TOP], 1u);
            const unsigned tg = og / nx;
            if (og + 1u == (tg + 1u) * nx) xb_add(&bar[XB_TOPGEN], 1u);
            else XB_SPIN(xb_ld(&bar[XB_TOPGEN]) == tg, bar);
            __builtin_amdgcn_fence(__ATOMIC_ACQUIRE, "agent");
            xb_add(&bar[XB_XGEN(b.x)], 1u);
            asm volatile("s_waitcnt vmcnt(0)" ::: "memory");
        } else {
            XB_SPIN(xb_ld(&bar[XB_XGEN(b.x)]) == gen, bar);
            __builtin_amdgcn_fence(__ATOMIC_ACQUIRE, "agent");
            asm volatile("s_waitcnt vmcnt(0)" ::: "memory");
        }
    }
    __syncthreads();
}

struct Frame {
    LAS unsigned char* lds;
    volatile LAS unsigned* MISC;
    gu32* ctl;
    int tid, lane, wave, G;
    const float *x, *mem, *w_in, *b_forget, *w_mem_kv, *w_out, *g_pre, *g_post, *g_mem, *rel_bias;
    float* out;
    f16_t *W1T, *W2T, *H, *P, *MKV, *Y;
    float *LF, *NC, *HBP, *KMP, *O32;
};

__device__ __forceinline__ float wave_sum(float v) {
#pragma unroll
    for (int o = 1; o < 64; o <<= 1) v += __shfl_xor(v, o);
    return v;
}
__device__ __forceinline__ float log_sigmoid_f(float z) { return fminf(z, 0.f) - log1pf(expf(-fabsf(z))); }

__device__ __forceinline__ void p0_transpose_item(const float* W, int ldw, int K, int src_c0, f16_t* WT, int dst_r0, int kb, LAS float* scr, int lane) {
    const int k0 = 64 * kb;
#pragma unroll 8
    for (int i = 0; i < 32; ++i) { const int kk = 2 * i + (lane >> 5); scr[kk * 33 + (lane & 31)] = W[(size_t)(k0 + kk) * ldw + src_c0 + (lane & 31)]; }
    LDS_WAIT(); asm volatile("" ::: "memory");
    const int c = lane & 7;
#pragma unroll
    for (int j = 0; j < 4; ++j) { const int n = (lane >> 3) + 8 * j; const LAS float* s = scr + (8 * c) * 33 + n;
        u32x4 o; o.x = pkh(s[0 * 33], s[1 * 33]); o.y = pkh(s[2 * 33], s[3 * 33]); o.z = pkh(s[4 * 33], s[5 * 33]); o.w = pkh(s[6 * 33], s[7 * 33]);
        *(GAS u32x4*)(WT + (size_t)(dst_r0 + n) * K + k0 + 8 * c) = o; }
    LDS_WAIT(); asm volatile("" ::: "memory");
}

__device__ __forceinline__ void p0_xrows(Frame& F) {
    LAS float* wf = (LAS float*)(F.lds);
    LAS float* hbuf = (LAS float*)(F.lds + 49152);
    for (int idx = F.tid; idx < 6 * DM; idx += NWAVES * 64) { const int k = idx / 6, i = idx - 6 * k; wf[i * DM + k] = F.w_in[(size_t)k * INW + FB_COL + i]; }
    f32x4 gp[8];
#pragma unroll
    for (int j = 0; j < 8; ++j) gp[j] = ((const GAS f32x4*)F.g_pre)[F.lane + 64 * j];
    __syncthreads();
    for (int it = blockIdx.x; it < MTOK / 32; it += F.G) {
        f32x4 hs[8];
#pragma unroll
        for (int j = 0; j < 8; ++j) hs[j] = (f32x4){0.f, 0.f, 0.f, 0.f};
#pragma unroll 1
        for (int rr = 0; rr < 4; ++rr) {
            const int m = it * 32 + F.wave * 4 + rr;
            asm volatile("" ::: "memory");
            const GAS f32x4* xr = (const GAS f32x4*)(F.x + (size_t)m * DM) + F.lane;
            f32x4 v[8]; float ss = 0.f;
#pragma unroll
            for (int j = 0; j < 8; ++j) { v[j] = xr[64 * j]; ss += (v[j].x * v[j].x + v[j].y * v[j].y) + (v[j].z * v[j].z + v[j].w * v[j].w); }
            ss = wave_sum(ss);
            const float rstd = 1.0f / sqrtf(ss * (1.0f / DM) + RMS_EPS);
            float d0 = 0.f, d1 = 0.f, d2 = 0.f, d3 = 0.f, d4 = 0.f, d5 = 0.f;
            GAS u32x2* hr = (GAS u32x2*)(F.H + (size_t)m * DM) + F.lane;
#pragma unroll
            for (int j = 0; j < 8; ++j) {
                const f32x4 h = (v[j] * rstd) * gp[j]; hs[j] += h;
                hr[64 * j] = (u32x2){pkh(h.x, h.y), pkh(h.z, h.w)};
                const LAS f32x4* wp = (const LAS f32x4*)(wf + 4 * (F.lane + 64 * j));
                f32x4 w;
                w = wp[0 * (DM / 4)]; d0 += (h.x * w.x + h.y * w.y) + (h.z * w.z + h.w * w.w);
                w = wp[1 * (DM / 4)]; d1 += (h.x * w.x + h.y * w.y) + (h.z * w.z + h.w * w.w);
                w = wp[2 * (DM / 4)]; d2 += (h.x * w.x + h.y * w.y) + (h.z * w.z + h.w * w.w);
                w = wp[3 * (DM / 4)]; d3 += (h.x * w.x + h.y * w.y) + (h.z * w.z + h.w * w.w);
                w = wp[4 * (DM / 4)]; d4 += (h.x * w.x + h.y * w.y) + (h.z * w.z + h.w * w.w);
                w = wp[5 * (DM / 4)]; d5 += (h.x * w.x + h.y * w.y) + (h.z * w.z + h.w * w.w);
            }
            d0 = wave_sum(d0); d1 = wave_sum(d1); d2 = wave_sum(d2); d3 = wave_sum(d3); d4 = wave_sum(d4); d5 = wave_sum(d5);
            if (F.lane < 6) {
                const float dd = F.lane == 0 ? d0 : F.lane == 1 ? d1 : F.lane == 2 ? d2 : F.lane == 3 ? d3 : F.lane == 4 ? d4 : d5;
                const float z = dd + F.b_forget[F.lane];
                F.LF[((size_t)(m >> 11) * 6 + F.lane) * SEQ + (m & (SEQ - 1))] = log_sigmoid_f(z);
            }
        }
#pragma unroll
        for (int j = 0; j < 8; ++j) *(LAS f32x4*)(hbuf + F.wave * DM + 4 * (F.lane + 64 * j)) = hs[j];
        __syncthreads();
        { f32x4 s = (f32x4){0.f, 0.f, 0.f, 0.f};
#pragma unroll
          for (int w = 0; w < 8; ++w) s += *(const LAS f32x4*)(hbuf + w * DM + 4 * F.tid);
          *(GAS f32x4*)(F.HBP + (size_t)it * DM + 4 * F.tid) = s; }
        __syncthreads();
    }
}
__device__ __forceinline__ void norm_row_f16(Frame& F, const float* xrow, const float* g, f16_t* orow) {
    const GAS f32x4* xr = (const GAS f32x4*)xrow + F.lane; const GAS f32x4* gr = (const GAS f32x4*)g + F.lane;
    f32x4 v[8]; float ss = 0.f;
#pragma unroll
    for (int j = 0; j < 8; ++j) { v[j] = xr[64 * j]; ss += (v[j].x * v[j].x + v[j].y * v[j].y) + (v[j].z * v[j].z + v[j].w * v[j].w); }
    ss = wave_sum(ss);
    const float rstd = 1.0f / sqrtf(ss * (1.0f / DM) + RMS_EPS);
    GAS u32x2* hr = (GAS u32x2*)orow + F.lane;
#pragma unroll
    for (int j = 0; j < 8; ++j) { const f32x4 h = (v[j] * rstd) * gr[64 * j]; hr[64 * j] = (u32x2){pkh(h.x, h.y), pkh(h.z, h.w)}; }
}
__device__ __forceinline__ void p0_prologue(Frame& F) {
    p0_xrows(F);
    __syncthreads();
    LAS float* scr = (LAS float*)(F.lds + F.wave * 16384);
    const int gw = blockIdx.x * NWAVES + F.wave, NGW = F.G * NWAVES;
    constexpr int I_1 = (DM / 64) * (N1 / 32), I_M = (DM / 64) * (NMKV / 32), I_2 = (DM / 64) * (DM / 32);
    for (int it = gw; it < I_1 + I_M + I_2; it += NGW) {
        int r = it;
        if (r < I_1) { const int kb = r / (N1 / 32), nb = r % (N1 / 32), n0 = 32 * nb; p0_transpose_item(F.w_in, INW, DM, n0 < FB_COL ? n0 : n0 + 6, F.W1T, n0, kb, scr, F.lane); continue; }
        r -= I_1;
        if (r < I_M) { const int kb = r / (NMKV / 32), nb = r % (NMKV / 32), n0 = 32 * nb; p0_transpose_item(F.w_mem_kv, NMKV, DM, n0, F.W1T, N1 + n0, kb, scr, F.lane); continue; }
        r -= I_M;
        { const int kb = r / (DM / 32), nb = r % (DM / 32), n0 = 32 * nb; p0_transpose_item(F.w_out, DM, DM, n0, F.W2T, n0, kb, scr, F.lane); }
    }
    for (int m = gw; m < MMEM; m += NGW) norm_row_f16(F, F.mem + (size_t)m * DM, F.g_mem, F.H + (size_t)(MTOK + m) * DM);
}

__device__ __forceinline__ void p1_scan_item(Frame& F, int it) {
    LAS float* tot = (LAS float*)(F.lds);
    const f32x4 v = ((const GAS f32x4*)(F.LF + (size_t)it * SEQ))[F.tid];
    const float a0 = v.x, a1 = a0 + v.y, a2 = a1 + v.z, a3 = a2 + v.w;
    float inc = a3;
#pragma unroll
    for (int o = 1; o < 64; o <<= 1) { const float t = __shfl_up(inc, o); if (F.lane >= o) inc += t; }
    if (F.lane == 63) tot[F.wave] = inc;
    __syncthreads();
    float woff = 0.f;
#pragma unroll
    for (int w = 0; w < 8; ++w) if (w < F.wave) woff += tot[w];
    const float base = woff + (inc - a3);
    const float s = -att::INV_SCALE;
    ((GAS f32x4*)(F.NC + (size_t)it * SEQ))[F.tid] = (f32x4){(base + a0) * s, (base + a1) * s, (base + a2) * s, (base + a3) * s};
    __syncthreads();
}
__device__ __forceinline__ void p1_kmean_item(Frame& F, int it) {
    const int cc = it >> 3, kc = it & 7;
    LAS float* hb = (LAS float*)(F.lds);
    LAS float* red = (LAS float*)(F.lds + 32768);
    for (int idx = F.tid; idx < 32 * 256; idx += NWAVES * 64) { const int bn = idx >> 8, kk = idx & 255; float s = 0.f;
#pragma unroll
        for (int sub = 0; sub < 8; ++sub) s += F.HBP[(size_t)(bn * 8 + sub) * DM + kc * 256 + kk];
        hb[idx] = s; }
    __syncthreads();
    const int c = F.tid & 63, kg = F.tid >> 6;
    float acc[32];
#pragma unroll
    for (int bn = 0; bn < 32; ++bn) acc[bn] = 0.f;
    const float* wcol = F.w_in + (size_t)(kc * 256 + kg * 32) * INW + 768 + cc * 64 + c;
    for (int k4 = 0; k4 < 8; ++k4) {
        const float w0 = wcol[(size_t)(4 * k4 + 0) * INW], w1 = wcol[(size_t)(4 * k4 + 1) * INW], w2 = wcol[(size_t)(4 * k4 + 2) * INW], w3 = wcol[(size_t)(4 * k4 + 3) * INW];
#pragma unroll
        for (int bn = 0; bn < 32; ++bn) { const f32x4 hv = *(const LAS f32x4*)(hb + bn * 256 + kg * 32 + 4 * k4); acc[bn] += (w0 * hv.x + w1 * hv.y) + (w2 * hv.z + w3 * hv.w); }
    }
#pragma unroll
    for (int bn = 0; bn < 32; ++bn) red[(kg * 32 + bn) * 64 + c] = acc[bn];
    __syncthreads();
#pragma unroll
    for (int q = 0; q < 4; ++q) { const int o = F.tid + 512 * q, bn = o >> 6, cq = o & 63; float s = 0.f;
#pragma unroll
        for (int g = 0; g < 8; ++g) s += red[(g * 32 + bn) * 64 + cq];
        F.KMP[(size_t)(kc * 32 + bn) * 768 + cc * 64 + cq] = s * (1.0f / 256.0f); }
    __syncthreads();
}

struct Sched1 {
    int G, c;
    __device__ __forceinline__ bool next(int i, pg8::Unit& u) const {
        const int L = i * G + c;
        constexpr int nM = MTOK / 256, nN = N1 / 256, nwg = nM * nN;
        if (L >= nwg + 16) return false;
        if (L >= nwg) { const int j = L - nwg; u.pm = nM + (j >> 2); u.pn = nN + (j & 3); return true; }
        int wgid = L; { const int q = nwg / 8, xcd = wgid % 8, off = wgid / 8; wgid = xcd * q + off; }
        const int nig = 8 * nN, gid = wgid / nig, fm = gid * 8;
        u.pm = fm + ((wgid % nig) % 8); u.pn = (wgid % nig) / 8; return true;
    }
};
struct Sched2 {
    int G, c;
    __device__ __forceinline__ bool next(int i, pg8::Unit& u) const {
        const int L = i * G + c;
        constexpr int nM = MTOK / 256, nN = DM / 256, nwg = nM * nN;
        if (L >= nwg) return false;
        int wgid = L; { const int q = nwg / 8, xcd = wgid % 8, off = wgid / 8; wgid = xcd * q + off; }
        const int nig = 8 * nN, gid = wgid / nig, fm = gid * 8;
        u.pm = fm + ((wgid % nig) % 8); u.pn = (wgid % nig) / 8; return true;
    }
};
struct EpiSlots {
    static constexpr bool PERM = true, AFTER_DRAIN = false;
    f16_t* P; f16_t* MKV;
    __device__ __forceinline__ void operator()(const f32x4 (&acc)[2][2][4][2], const pg8::Unit& u, int wr, int wc, int fr, int fq) const {
        const bool is_mem = u.pm >= MTOK / 256;
        const int row0 = (is_mem ? (u.pm - MTOK / 256) : u.pm) * 256 + wr * 64 + fr;
#pragma unroll
        for (int bj = 0; bj < 2; ++bj) {
            f16_t* base = is_mem ? MKV + (size_t)(2 * (u.pn - N1 / 256) + bj) * MKV_SLOT_ELEMS : P + (size_t)(2 * u.pn + bj) * SLOT_ELEMS;
            base += wc * 32 + 8 * fq;
#pragma unroll
            for (int ai = 0; ai < 2; ++ai)
#pragma unroll
                for (int m = 0; m < 4; ++m) { const f32x4 v0 = acc[ai][bj][m][0], v1 = acc[ai][bj][m][1];
                    u32x4 w; w.x = pkh(v0[0], v0[1]); w.y = pkh(v0[2], v0[3]); w.z = pkh(v1[0], v1[1]); w.w = pkh(v1[2], v1[3]);
                    *(u32x4*)(base + (size_t)(row0 + ai * 128 + m * 16) * 128) = w; }
        }
    }
};
struct EpiF32 {
    static constexpr bool PERM = false, AFTER_DRAIN = false;
    float* O; int ldc;
    __device__ __forceinline__ void operator()(const f32x4 (&acc)[2][2][4][2], const pg8::Unit& u, int wr, int wc, int fr, int fq) const {
        const int row0 = u.pm * 256 + wr * 64 + fr, col0 = u.pn * 256 + wc * 32 + 4 * fq;
#pragma unroll
        for (int ai = 0; ai < 2; ++ai)
#pragma unroll
            for (int m = 0; m < 4; ++m) { float* rowp = O + (size_t)(row0 + ai * 128 + m * 16) * ldc + col0;
#pragma unroll
                for (int bj = 0; bj < 2; ++bj)
#pragma unroll
                    for (int n = 0; n < 2; ++n) *(f32x4*)(rowp + bj * 128 + n * 16) = acc[ai][bj][m][n]; }
    }
};

__device__ __forceinline__ void p4_final(Frame& F) {
    const int gw = blockIdx.x * NWAVES + F.wave, NGW = F.G * NWAVES;
    f32x4 gp[8];
#pragma unroll
    for (int j = 0; j < 8; ++j) gp[j] = ((const GAS f32x4*)F.g_post)[F.lane + 64 * j];
    for (int m = gw; m < MTOK; m += NGW) {
        const GAS f32x4* orow = (const GAS f32x4*)(F.O32 + (size_t)m * DM) + F.lane;
        const GAS f32x4* xr = (const GAS f32x4*)(F.x + (size_t)m * DM) + F.lane;
        GAS f32x4* dst = (GAS f32x4*)(F.out + (size_t)m * DM) + F.lane;
        f32x4 v[8]; float ss = 0.f;
#pragma unroll
        for (int j = 0; j < 8; ++j) { v[j] = orow[64 * j]; ss += (v[j].x * v[j].x + v[j].y * v[j].y) + (v[j].z * v[j].z + v[j].w * v[j].w); }
        ss = wave_sum(ss);
        const float rstd = 1.0f / sqrtf(ss * (1.0f / DM) + RMS_EPS);
#pragma unroll
        for (int j = 0; j < 8; ++j) dst[64 * j] = xr[64 * j] + (v[j] * rstd) * gp[j];
    }
}

__device__ __forceinline__ att::BlockRef make_ref(const Frame& F, int u) {
    att::BlockRef r;
    if (u < 192) { const int bh = u >> 3, qb = u & 7, b = bh / 6, h = bh - 6 * b; const size_t row0 = (size_t)b * SEQ + qb * 256;
        r.Q = F.P + (size_t)(0 + h) * SLOT_ELEMS + row0 * 128; r.K = F.P + (size_t)(6 + h) * SLOT_ELEMS + (size_t)b * SEQ * 128; r.V = F.P + (size_t)(12 + h) * SLOT_ELEMS + (size_t)b * SEQ * 128;
        r.Gt = F.P + (size_t)(18 + h) * SLOT_ELEMS + row0 * 128; r.Y = F.Y + row0 * DM + h * 128;
        r.aux = F.KMP + (size_t)(b * 8) * 768 + h * 128; r.rb = F.rel_bias + h * 32; r.P0 = qb * 256; r.NT = 4 * (qb + 1); r.mode = 0; r.qb = qb; }
    else if (u < 384) { const int v = u - 192, bh = v >> 3, qb = v & 7, b = bh / 6, h = bh - 6 * b; const size_t row0 = (size_t)b * SEQ + qb * 256;
        r.Q = F.P + (size_t)(24 + h) * SLOT_ELEMS + row0 * 128; r.K = F.P + (size_t)(30 + h) * SLOT_ELEMS + (size_t)b * SEQ * 128; r.V = F.P + (size_t)(36 + h) * SLOT_ELEMS + (size_t)b * SEQ * 128;
        r.Gt = F.P + (size_t)(42 + h) * SLOT_ELEMS + row0 * 128; r.Y = F.Y + row0 * DM + 768 + h * 128;
        r.aux = F.NC + (size_t)(b * 6 + h) * SEQ; r.rb = F.rel_bias; r.P0 = qb * 256; r.NT = 4 * (qb + 1); r.mode = 1; r.qb = qb; }
    else { const int v = u - 384, bh = v >> 3, qb = v & 7, b = bh >> 2, h = bh & 3; const size_t row0 = (size_t)b * SEQ + qb * 256;
        r.Q = F.P + (size_t)(48 + h) * SLOT_ELEMS + row0 * 128; r.K = F.MKV + (size_t)h * MKV_SLOT_ELEMS + (size_t)b * NMEM * 128; r.V = F.MKV + (size_t)(4 + h) * MKV_SLOT_ELEMS + (size_t)b * NMEM * 128;
        r.Gt = F.P + (size_t)(52 + h) * SLOT_ELEMS + row0 * 128; r.Y = F.Y + row0 * DM + 1536 + h * 128;
        r.aux = F.NC; r.rb = F.rel_bias; r.P0 = qb * 256; r.NT = 4; r.mode = 2; r.qb = qb; }
    return r;
}
__device__ __forceinline__ int att_unit_of(int G, int i) {
    if (G == 256) return i < ATT_MAXU ? (int)att_sched[blockIdx.x][i] : -1;
    const int u = (int)blockIdx.x + i * G; return u < 512 ? u : -1;
}
#ifndef MK_N_LAUNCHES
#define MK_N_LAUNCHES 1
#endif
constexpr int N_LAUNCHES = MK_N_LAUNCHES;
constexpr int PER_PHASE = 5;
struct Args { const float* in[10]; float* out; unsigned char* ws; int ph_lo, ph_hi; };
__global__ void __launch_bounds__(NWAVES * 64, 2) fused_fwd(Args args) {
    extern __shared__ __attribute__((aligned(16))) unsigned char lds[];
    Frame F;
    F.lds = (LAS unsigned char*)lds;
    F.MISC = (volatile LAS unsigned*)(F.lds + MISC_OFF);
    F.tid = threadIdx.x; F.lane = F.tid & 63; F.wave = __builtin_amdgcn_readfirstlane(F.tid >> 6);
    F.G = gridDim.x;
    unsigned char* ws = args.ws;
    F.ctl = (gu32*)(ws + WS_CTL);
    F.x = args.in[0]; F.mem = args.in[1]; F.w_in = args.in[2]; F.b_forget = args.in[3]; F.w_mem_kv = args.in[4]; F.w_out = args.in[5];
    F.g_pre = args.in[6]; F.g_post = args.in[7]; F.g_mem = args.in[8]; F.rel_bias = args.in[9]; F.out = args.out;
    F.W1T = (f16_t*)(ws + WS_W1T); F.W2T = (f16_t*)(ws + WS_W2T); F.H = (f16_t*)(ws + WS_H); F.P = (f16_t*)(ws + WS_P); F.MKV = (f16_t*)(ws + WS_MKV); F.Y = (f16_t*)(ws + WS_Y);
    F.LF = (float*)(ws + WS_LF); F.NC = (float*)(ws + WS_NC); F.HBP = (float*)(ws + WS_HBP); F.KMP = (float*)(ws + WS_KMP); F.O32 = (float*)(ws + WS_O32);
    for (int u = F.tid; u < (LDS_BYTES - LDSCTL_OFF) / 4; u += NWAVES * 64) ((LAS unsigned*)(F.lds + LDSCTL_OFF))[u] = 0u;
    __syncthreads();
    XcdBarrier bar; bar.bar = (unsigned*)(F.ctl + CW_BAR); bar.x = 0; bar.st = nullptr;
    if (N_LAUNCHES == 1) bar = xcd_barrier_post((unsigned*)(F.ctl + CW_BAR), F.MISC + 8);
#define GRID_BAR() do { if (N_LAUNCHES == 1) xcd_barrier(bar); } while (0)
    const int lo = args.ph_lo, hi = args.ph_hi;
#ifndef PH_MASK
#define PH_MASK 31
#endif
#define IN(k) (((PH_MASK >> (k)) & 1) && lo <= (k) && (k) < hi)
#define BOTH(k) (IN(k) && IN((k) + 1))

    if (IN(0)) { p0_prologue(F); if (BOTH(0)) GRID_BAR(); }

    if (IN(1)) {
        for (int it = blockIdx.x; it < 24 + 96; it += F.G) { if (it < 24) p1_scan_item(F, it); else p1_kmean_item(F, it - 24); }
        __syncthreads();
        pg8::Gemm g{F.H, F.W1T, DM}; Sched1 S{F.G, (int)blockIdx.x}; EpiSlots E{F.P, F.MKV};
        pg8::gemm_phase<EpiSlots, Sched1, true>(F.lds, g, S, E);
        if (BOTH(1)) GRID_BAR();
    }

    if (IN(2)) {
        int u = att_unit_of(F.G, 0);
        if (u >= 0) {
            att::BlockRef cur = make_ref(F, u); att::Seam S;
            att::attn_prime(cur, (char*)lds, S);
            for (int i = 0;; ++i) {
                const int un = att_unit_of(F.G, i + 1);
                const bool last = un < 0;
                const att::BlockRef nxt = last ? cur : make_ref(F, un);
                att::attn_block(cur, nxt, (char*)lds, S);
                if (last) break;
                cur = nxt;
            }
        }
        if (BOTH(2)) GRID_BAR();
    }

    if (IN(3)) {
        pg8::Gemm g{F.Y, F.W2T, DM}; Sched2 S{F.G, (int)blockIdx.x}; EpiF32 E{F.O32, DM};
        pg8::gemm_phase<EpiF32, Sched2, false>(F.lds, g, S, E);
        if (BOTH(3)) GRID_BAR();
    }

    if (IN(4)) { p4_final(F); }
#undef IN
#undef BOTH
#undef GRID_BAR
}

extern "C" void kernel_launch(void* const* d_in, const int* in_sizes, int n_in, void* d_out, int out_size, void* d_ws, size_t ws_size, hipStream_t stream) {
    static int grid = 0;
    if (grid == 0) {
        if (n_in != 10 || in_sizes[0] != MTOK * DM || out_size != MTOK * DM || ws_size < WS_END) { fprintf(stderr, "kernel_launch: unexpected shapes / workspace (n_in %d, in0 %d, out %d, ws %zu); nothing launched\n", n_in, n_in > 0 ? in_sizes[0] : -1, out_size, ws_size); grid = -1; return; }
        int dev = 0, cus = 0, per_cu = 0;
        if (hipGetDevice(&dev) != hipSuccess || hipDeviceGetAttribute(&cus, hipDeviceAttributeMultiprocessorCount, dev) != hipSuccess) { fprintf(stderr, "kernel_launch: device query failed\n"); grid = -1; return; }
        if (hipFuncSetAttribute((const void*)fused_fwd, hipFuncAttributeMaxDynamicSharedMemorySize, LDS_BYTES) != hipSuccess) { fprintf(stderr, "kernel_launch: hipFuncSetAttribute failed\n"); grid = -1; return; }
        if (hipOccupancyMaxActiveBlocksPerMultiprocessor(&per_cu, (const void*)fused_fwd, NWAVES * 64, LDS_BYTES) != hipSuccess || per_cu < 1) { fprintf(stderr, "kernel_launch: occupancy query reports %d workgroups per CU\n", per_cu); }
        (void)hipGetLastError();
        grid = cus;
    }
    if (grid < 0) return;
    if (hipMemsetAsync((char*)d_ws + WS_CTL, 0, CTL_ZERO_BYTES, stream) != hipSuccess) { fprintf(stderr, "kernel_launch: hipMemsetAsync failed\n"); return; }
    Args a{};
    for (int i = 0; i < 10; ++i) a.in[i] = (const float*)d_in[i];
    a.out = (float*)d_out; a.ws = (unsigned char*)d_ws;
    for (int li = 0; li < N_LAUNCHES; ++li) {
        a.ph_lo = (N_LAUNCHES == 1) ? 0 : li; a.ph_hi = (N_LAUNCHES == 1) ? PER_PHASE : li + 1;
        hipLaunchKernelGGL(fused_fwd, dim3(grid), dim3(NWAVES * 64), LDS_BYTES, stream, a);
        const hipError_t le = hipPeekAtLastError();
        if (le != hipSuccess) { fprintf(stderr, "kernel_launch: launch %d failed: %s\n", li, hipGetErrorName(le)); break; }
    }
}
```
